# Optimizing an MI355X kernel written in HIP

```python
import math
import jax, jax.numpy as jnp
from jax import lax
import numpy as np

D_MODEL = 2048
BATCH = 4
SEQ = 2048
DEPTH = 1

MIX_WIDTH = D_MODEL
ATTN_HEADS = 8
HEAD_DIM = 128
ATTN_WIDTH = ATTN_HEADS * HEAD_DIM
LRU_HEADS = 8
LRU_WIDTH = MIX_WIDTH - ATTN_WIDTH
LRU_BLOCK = LRU_WIDTH // LRU_HEADS
CONV_WIDTH = 4
LRU_C = 8.0
D_FF = 4 * D_MODEL
Q_BLOCK = 128
N_MOD = 6
IN_COLS = 3 * ATTN_WIDTH + 2 * LRU_WIDTH
EPS = 1e-6

kernel_name = "hymba_stickbreak_rglru_sqrelu_adaln"


def rmsnorm(x, g):
    x32 = x.astype(jnp.float32)
    y = x32 * lax.rsqrt(jnp.mean(x32 * x32, axis=-1, keepdims=True) + EPS)
    return (y * g.astype(jnp.float32)).astype(x.dtype)


def stick_breaking_attention(q, k, v):
    B, S, H, Dh = q.shape
    scale = Dh ** -0.5
    outs = []
    for i in range(S // Q_BLOCK):
        q0 = i * Q_BLOCK
        kend = q0 + Q_BLOCK
        qb = q[:, q0:kend].astype(jnp.float32)
        kb = k[:, :kend].astype(jnp.float32)
        vb = v[:, :kend].astype(jnp.float32)
        z = jnp.einsum('bqhd,bkhd->bhqk', qb, kb) * scale
        t_idx = q0 + jnp.arange(Q_BLOCK)[:, None]
        s_idx = jnp.arange(kend)[None, :]
        causal = s_idx < t_idx
        log_beta = jax.nn.log_sigmoid(z)
        log_stay = jnp.where(causal, jax.nn.log_sigmoid(-z), 0.0)
        rev = lax.cumsum(log_stay, axis=3, reverse=True)
        after = jnp.concatenate([rev[..., 1:], jnp.zeros_like(rev[..., :1])], axis=-1)
        w = jnp.where(causal, jnp.exp(log_beta + after), 0.0)
        outs.append(jnp.einsum('bhqk,bkhd->bqhd', w, vb))
    return jnp.concatenate(outs, axis=1).astype(q.dtype)


def causal_depthwise_conv(x, w, b):
    C = x.shape[-1]
    y = lax.conv_general_dilated(
        x.astype(jnp.float32), w.astype(jnp.float32)[:, None, :],
        window_strides=(1,), padding=[(CONV_WIDTH - 1, 0)],
        dimension_numbers=('NWC', 'WIO', 'NWC'), feature_group_count=C)
    return y + b.astype(jnp.float32)


def rg_lru(x, w_a, b_a, w_x, b_x, lam):
    B, S, _ = x.shape
    xh = x.reshape(B, S, LRU_HEADS, LRU_BLOCK)
    r = jax.nn.sigmoid(jnp.einsum('bshc,hcd->bshd', xh, w_a.astype(jnp.float32)).reshape(B, S, LRU_WIDTH) + b_a)
    i = jax.nn.sigmoid(jnp.einsum('bshc,hcd->bshd', xh, w_x.astype(jnp.float32)).reshape(B, S, LRU_WIDTH) + b_x)
    log_a = -LRU_C * r * jax.nn.softplus(-lam.astype(jnp.float32))
    a = jnp.exp(log_a)
    u = jnp.sqrt(-jnp.expm1(2.0 * log_a)) * (i * x)

    def combine(left, right):
        a1, b1 = left
        a2, b2 = right
        return a1 * a2, a2 * b1 + b2

    _, h = lax.associative_scan(combine, (a, u), axis=1)
    return h


def setup_inputs(seed: int = 0) -> dict:
    key = jax.random.key(seed)
    ks = jax.random.split(key, 24)
    f32 = jnp.float32
    nrm = lambda k, shape, s: jax.random.normal(k, shape, f32) * s
    u = jax.random.uniform(ks[11], (DEPTH, LRU_WIDTH), f32, 0.9, 0.999)
    a_base = u ** (1.0 / LRU_C)
    lru_lambda = jnp.log(a_base) - jnp.log1p(-a_base)
    return {
        "x": nrm(ks[0], (BATCH, SEQ, D_MODEL), 1.0),
        "c": nrm(ks[1], (BATCH, D_MODEL), 1.0),
        "w_ada": nrm(ks[2], (DEPTH, D_MODEL, N_MOD * D_MODEL), 0.5 * D_MODEL ** -0.5),
        "b_ada": nrm(ks[3], (DEPTH, N_MOD * D_MODEL), 0.02),
        "g_norm_mix": 1.0 + nrm(ks[4], (DEPTH, D_MODEL), 0.02),
        "w_in": nrm(ks[5], (DEPTH, D_MODEL, IN_COLS), D_MODEL ** -0.5),
        "w_conv": nrm(ks[6], (DEPTH, CONV_WIDTH, LRU_WIDTH), CONV_WIDTH ** -0.5),
        "b_conv": nrm(ks[7], (DEPTH, LRU_WIDTH), 0.02),
        "w_rg_a": nrm(ks[8], (DEPTH, LRU_HEADS, LRU_BLOCK, LRU_BLOCK), LRU_BLOCK ** -0.5),
        "b_rg_a": nrm(ks[9], (DEPTH, LRU_WIDTH), 0.02),
        "w_rg_x": nrm(ks[10], (DEPTH, LRU_HEADS, LRU_BLOCK, LRU_BLOCK), LRU_BLOCK ** -0.5),
        "b_rg_x": nrm(ks[12], (DEPTH, LRU_WIDTH), 0.02),
        "lru_lambda": lru_lambda,
        "g_attn_out": 1.0 + nrm(ks[13], (DEPTH, ATTN_WIDTH), 0.02),
        "g_lru_out": 1.0 + nrm(ks[14], (DEPTH, LRU_WIDTH), 0.02),
        "w_out": nrm(ks[15], (DEPTH, MIX_WIDTH, D_MODEL), MIX_WIDTH ** -0.5),
        "g_norm_mlp": 1.0 + nrm(ks[16], (DEPTH, D_MODEL), 0.02),
        "w_mlp_in": nrm(ks[17], (DEPTH, D_MODEL, D_FF), D_MODEL ** -0.5),
        "w_mlp_out": nrm(ks[18], (DEPTH, D_FF, D_MODEL), D_FF ** -0.5),
        "g_norm_final": 1.0 + nrm(ks[19], (D_MODEL,), 0.02),
    }


def reference(x, c, w_ada, b_ada, g_norm_mix, w_in, w_conv, b_conv, w_rg_a, b_rg_a,
              w_rg_x, b_rg_x, lru_lambda, g_attn_out, g_lru_out, w_out, g_norm_mlp,
              w_mlp_in, w_mlp_out, g_norm_final):
    B, S, D = x.shape
    c_act = jax.nn.silu(c.astype(jnp.float32))
    for l in range(DEPTH):
        mod = (c_act @ w_ada[l].astype(jnp.float32) + b_ada[l]).reshape(B, N_MOD, D)
        sh1, sc1, gt1, sh2, sc2, gt2 = [mod[:, j][:, None, :] for j in range(N_MOD)]

        h = rmsnorm(x, g_norm_mix[l]).astype(jnp.float32) * (1.0 + sc1) + sh1
        proj = jnp.einsum('bsd,de->bse', h, w_in[l].astype(jnp.float32))
        q, k, v, xr, xg = jnp.split(
            proj, np.cumsum([ATTN_WIDTH, ATTN_WIDTH, ATTN_WIDTH, LRU_WIDTH]).tolist(), axis=-1)

        to_heads = lambda t: t.reshape(B, S, ATTN_HEADS, HEAD_DIM)
        o_attn = stick_breaking_attention(to_heads(q), to_heads(k), to_heads(v)).reshape(B, S, ATTN_WIDTH)

        xr = causal_depthwise_conv(xr, w_conv[l], b_conv[l])
        hr = rg_lru(xr, w_rg_a[l], b_rg_a[l], w_rg_x[l], b_rg_x[l], lru_lambda[l])
        o_lru = hr * jax.nn.gelu(xg, approximate=True)

        mixed = jnp.concatenate([rmsnorm(o_attn, g_attn_out[l]), rmsnorm(o_lru, g_lru_out[l])], axis=-1)
        y = jnp.einsum('bse,ed->bsd', mixed, w_out[l].astype(jnp.float32))
        x = (x.astype(jnp.float32) + gt1 * y).astype(x.dtype)

        h = rmsnorm(x, g_norm_mlp[l]).astype(jnp.float32) * (1.0 + sc2) + sh2
        hid = jnp.square(jax.nn.relu(jnp.einsum('bsd,df->bsf', h, w_mlp_in[l].astype(jnp.float32))))
        y = jnp.einsum('bsf,fd->bsd', hid, w_mlp_out[l].astype(jnp.float32))
        x = (x.astype(jnp.float32) + gt2 * y).astype(x.dtype)

    return rmsnorm(x, g_norm_final)
```

```cpp
#include <hip/hip_runtime.h>
#include <cstdio>
#include <cstdint>

namespace nv {
constexpr int B = 4, S = 2048, D = 2048, M = B * S;
constexpr int AW = 1024, LW = 1024, NH = 8, HD = 128, INC = 5120, FF = 8192, NMOD = 6;
constexpr float EPS = 1e-6f;

__device__ __forceinline__ float block_sum256(float v, float* red) {
    for (int o = 32; o > 0; o >>= 1) v += __shfl_xor(v, o);
    const int w = threadIdx.x >> 6, l = threadIdx.x & 63;
    __syncthreads();
    if (l == 0) red[w] = v;
    __syncthreads();
    return red[0] + red[1] + red[2] + red[3];
}

__global__ void __launch_bounds__(256) k_ada(const float* c, const float* w, const float* bias, float* mod) {
    __shared__ float ca[B * D];
    for (int i = threadIdx.x; i < B * D; i += 256) { const float v = c[i]; ca[i] = v / (1.f + __expf(-v)); }
    __syncthreads();
    const int n = blockIdx.x * 256 + threadIdx.x;
    float a0 = 0, a1 = 0, a2 = 0, a3 = 0;
    for (int k = 0; k < D; ++k) { const float wv = w[(size_t)k * (NMOD * D) + n]; a0 += ca[k] * wv; a1 += ca[D + k] * wv; a2 += ca[2 * D + k] * wv; a3 += ca[3 * D + k] * wv; }
    const float bv = bias[n];
    mod[n] = a0 + bv; mod[NMOD * D + n] = a1 + bv; mod[2 * NMOD * D + n] = a2 + bv; mod[3 * NMOD * D + n] = a3 + bv;
}

__global__ void __launch_bounds__(256) k_norm_mod(const float* x, const float* g, const float* mod, int sh_i, int sc_i, float* out) {
    __shared__ float red[4];
    const int row = blockIdx.x, b = row / S;
    const float* xr = x + (size_t)row * D;
    float v[8]; float ss = 0;
    for (int j = 0; j < 8; ++j) { v[j] = xr[threadIdx.x + 256 * j]; ss += v[j] * v[j]; }
    ss = block_sum256(ss, red);
    const float rs = rsqrtf(ss / D + EPS);
    for (int j = 0; j < 8; ++j) { const int d = threadIdx.x + 256 * j; float y = v[j] * rs * g[d];
        if (mod) y = y * (1.f + mod[(size_t)b * NMOD * D + sc_i * D + d]) + mod[(size_t)b * NMOD * D + sh_i * D + d];
        out[(size_t)row * D + d] = y; }
}

template <int EPI>
__global__ void __launch_bounds__(256) k_gemm(const float* A, const float* Bm, float* C, int Mm, int N, int K, const float* res, const float* mod, int gate_i) {
    __shared__ float As[16][64 + 1], Bs[16][64 + 1];
    const int tx = threadIdx.x & 15, ty = threadIdx.x >> 4, m0 = blockIdx.y * 64, n0 = blockIdx.x * 64;
    float acc[4][4] = {};
    for (int k0 = 0; k0 < K; k0 += 16) {
        for (int i = threadIdx.x; i < 64 * 16; i += 256) { const int r = i >> 4, kk = i & 15; As[kk][r] = A[(size_t)(m0 + r) * K + k0 + kk]; }
        for (int i = threadIdx.x; i < 64 * 16; i += 256) { const int kk = i >> 6, cc = i & 63; Bs[kk][cc] = Bm[(size_t)(k0 + kk) * N + n0 + cc]; }
        __syncthreads();
#pragma unroll
        for (int kk = 0; kk < 16; ++kk) { float a[4], b[4];
#pragma unroll
            for (int i = 0; i < 4; ++i) { a[i] = As[kk][ty * 4 + i]; b[i] = Bs[kk][tx * 4 + i]; }
#pragma unroll
            for (int i = 0; i < 4; ++i)
#pragma unroll
                for (int j = 0; j < 4; ++j) acc[i][j] += a[i] * b[j]; }
        __syncthreads();
    }
    for (int i = 0; i < 4; ++i) for (int j = 0; j < 4; ++j) { const int r = m0 + ty * 4 + i, cn = n0 + tx * 4 + j; float v = acc[i][j];
        if (EPI == 1) { v = v > 0.f ? v * v : 0.f; }
        if (EPI == 2) { v = res[(size_t)r * N + cn] + mod[(size_t)(r / S) * NMOD * D + gate_i * D + cn] * v; }
        C[(size_t)r * N + cn] = v; }
}

__global__ void __launch_bounds__(256) k_attn(const float* proj, float* oattn) {
    const int gw = blockIdx.x * 4 + (threadIdx.x >> 6), lane = threadIdx.x & 63;
    const int t = gw % S, h = (gw / S) % NH, b = gw / (S * NH);
    const float scale = 0.08838834764831845f;
    const float* base = proj + (size_t)b * S * INC + h * HD;
    const float q0 = base[(size_t)t * INC + lane] * scale, q1 = base[(size_t)t * INC + 64 + lane] * scale;
    float o0 = 0, o1 = 0, carry = 0;
    for (int s = t - 1; s >= 0; --s) {
        const float* kr = base + (size_t)s * INC + AW; const float* vr = kr + AW;
        float z = q0 * kr[lane] + q1 * kr[64 + lane];
        for (int o = 32; o > 0; o >>= 1) z += __shfl_xor(z, o);
        const float lsig = fminf(z, 0.f) - log1pf(__expf(-fabsf(z)));
        const float w = __expf(lsig + carry);
        o0 += w * vr[lane]; o1 += w * vr[64 + lane];
        carry += lsig - z;
    }
    float* op = oattn + (size_t)(b * S + t) * AW + h * HD; op[lane] = o0; op[64 + lane] = o1;
}

__global__ void __launch_bounds__(256) k_conv(const float* proj, const float* wc, const float* bc, float* xc) {
    const int idx = blockIdx.x * 256 + threadIdx.x, row = idx / LW, c = idx % LW, t = row % S;
    float a = bc[c];
    for (int j = 0; j < 4; ++j) { const int tt = t - 3 + j; if (tt >= 0) a += wc[j * LW + c] * proj[(size_t)(row - 3 + j) * INC + 3 * AW + c]; }
    xc[idx] = a;
}
__global__ void __launch_bounds__(256) k_gates(const float* xc, const float* wa, const float* ba, const float* wx, const float* bx, const float* lam, float* av, float* uv) {
    const int idx = blockIdx.x * 256 + threadIdx.x, row = idx / LW, d = idx % LW, h = d / 128, dd = d % 128;
    const float* xr = xc + (size_t)row * LW + h * 128;
    float ga = 0, gx = 0;
    for (int c = 0; c < 128; ++c) { const float xv = xr[c]; ga += xv * wa[(size_t)(h * 128 + c) * 128 + dd]; gx += xv * wx[(size_t)(h * 128 + c) * 128 + dd]; }
    const float r = 1.f / (1.f + __expf(-(ga + ba[d]))), ig = 1.f / (1.f + __expf(-(gx + bx[d])));
    const float sp = log1pf(__expf(-lam[d]));
    const float la = -8.f * r * sp;
    av[idx] = __expf(la); uv[idx] = sqrtf(-expm1f(2.f * la)) * (ig * xc[idx]);
}
__global__ void __launch_bounds__(64) k_scan(const float* av, const float* uv, const float* proj, float* olru) {
    const int idx = blockIdx.x * 64 + threadIdx.x, b = idx / LW, d = idx % LW;
    float h = 0;
    for (int t = 0; t < S; ++t) { const size_t row = (size_t)b * S + t; h = av[row * LW + d] * h + uv[row * LW + d];
        const float g = proj[row * INC + 4 * AW + d]; const float ge = 0.5f * g * (1.f + tanhf(0.7978845608028654f * (g + 0.044715f * g * g * g)));
        olru[row * LW + d] = h * ge; }
}
__global__ void __launch_bounds__(256) k_mix(const float* oattn, const float* olru, const float* ga, const float* gl, float* mixed) {
    __shared__ float red[4];
    const int row = blockIdx.x;
    float va[4], vl[4], sa = 0, sl = 0;
    for (int j = 0; j < 4; ++j) { va[j] = oattn[(size_t)row * AW + threadIdx.x + 256 * j]; vl[j] = olru[(size_t)row * LW + threadIdx.x + 256 * j]; sa += va[j] * va[j]; sl += vl[j] * vl[j]; }
    sa = block_sum256(sa, red); sl = block_sum256(sl, red);
    const float ra = rsqrtf(sa / AW + EPS), rl = rsqrtf(sl / LW + EPS);
    for (int j = 0; j < 4; ++j) { const int d = threadIdx.x + 256 * j; mixed[(size_t)row * D + d] = va[j] * ra * ga[d]; mixed[(size_t)row * D + AW + d] = vl[j] * rl * gl[d]; }
}
}

extern "C" void kernel_launch(void* const* d_in, const int* in_sizes, int n_in, void* d_out, int out_size, void* d_ws, size_t ws_size, hipStream_t stream) {
    using namespace nv;
    const float* x = (const float*)d_in[0]; const float* c = (const float*)d_in[1]; const float* w_ada = (const float*)d_in[2]; const float* b_ada = (const float*)d_in[3];
    const float* g_mix = (const float*)d_in[4]; const float* w_in = (const float*)d_in[5]; const float* w_conv = (const float*)d_in[6]; const float* b_conv = (const float*)d_in[7];
    const float* w_rg_a = (const float*)d_in[8]; const float* b_rg_a = (const float*)d_in[9]; const float* w_rg_x = (const float*)d_in[10]; const float* b_rg_x = (const float*)d_in[11];
    const float* lam = (const float*)d_in[12]; const float* g_attn = (const float*)d_in[13]; const float* g_lru = (const float*)d_in[14]; const float* w_out = (const float*)d_in[15];
    const float* g_mlp = (const float*)d_in[16]; const float* w_mlp_in = (const float*)d_in[17]; const float* w_mlp_out = (const float*)d_in[18]; const float* g_final = (const float*)d_in[19];
    float* out = (float*)d_out;
    const size_t MiB = 1u << 20;
    if (ws_size < 352 * MiB) { fprintf(stderr, "kernel_launch: workspace too small: %zu\n", ws_size); return; }
    char* ws = (char*)d_ws;
    float* mod = (float*)(ws);
    float* bufA = (float*)(ws + 1 * MiB);
    float* proj = bufA; float* xc = (float*)(ws + 161 * MiB); float* av = (float*)(ws + 193 * MiB); float* uv = (float*)(ws + 225 * MiB);
    float* hid = bufA;
    float* bufB = (float*)(ws + 257 * MiB);
    float* oattn = bufB; float* olru = (float*)(ws + 289 * MiB);
    float* bufC = (float*)(ws + 161 * MiB);
    float* x1 = out;

    k_ada<<<NMOD * D / 256, 256, 0, stream>>>(c, w_ada, b_ada, mod);
    k_norm_mod<<<M, 256, 0, stream>>>(x, g_mix, mod, 0, 1, bufB);
    k_gemm<0><<<dim3(INC / 64, M / 64), 256, 0, stream>>>(bufB, w_in, proj, M, INC, D, nullptr, nullptr, 0);
    k_attn<<<B * NH * S / 4, 256, 0, stream>>>(proj, oattn);
    k_conv<<<M * LW / 256, 256, 0, stream>>>(proj, w_conv, b_conv, xc);
    k_gates<<<M * LW / 256, 256, 0, stream>>>(xc, w_rg_a, b_rg_a, w_rg_x, b_rg_x, lam, av, uv);
    k_scan<<<B * LW / 64, 64, 0, stream>>>(av, uv, proj, olru);
    k_mix<<<M, 256, 0, stream>>>(oattn, olru, g_attn, g_lru, bufC);
    k_gemm<2><<<dim3(D / 64, M / 64), 256, 0, stream>>>(bufC, w_out, x1, M, D, D, x, mod, 2);
    k_norm_mod<<<M, 256, 0, stream>>>(x1, g_mlp, mod, 3, 4, bufB);
    k_gemm<1><<<dim3(FF / 64, M / 64), 256, 0, stream>>>(bufB, w_mlp_in, hid, M, FF, D, nullptr, nullptr, 0);
    k_gemm<2><<<dim3(D / 64, M / 64), 256, 0, stream>>>(hid, w_mlp_out, x1, M, D, FF, x1, mod, 5);
    k_norm_mod<<<M, 256, 0, stream>>>(x1, g_final, nullptr, 0, 0, out);
}
```

```cpp
#include <hip/hip_runtime.h>
#include <cstdio>
#include <cstdint>
namespace pg8 {
#define PG8_LAS __attribute__((address_space(3)))
typedef unsigned short bf16_t;
typedef short bf16x8 __attribute__((ext_vector_type(8)));
typedef float f32x4 __attribute__((ext_vector_type(4)));
typedef unsigned u32x4 __attribute__((ext_vector_type(4)));
constexpr int BM = 256, BK = 64, HALF = 128, HTB = HALF * BK * 2  , STAGE_BYTES = 8 * HTB, NXCD = 8, WGM = 8;

__host__ __device__ __forceinline__ int lds_byte(int r, int c) { const int st = (r >> 4) * 2 + (c >> 5), rr = r & 15, cc = c & 31, ob = rr * 64 + cc * 2; return st * 1024 + (ob ^ (((ob >> 9) & 1) << 5)); }
__host__ __device__ __forceinline__ void stage_rc(int b, int& R, int& C) { const int st = b / 1024, sb = b % 1024, swz = sb ^ (((sb >> 9) & 1) << 5); R = (st >> 1) * 16 + swz / 64; C = (st & 1) * 32 + (swz % 64) / 2; }
__host__ __device__ __forceinline__ int perm32(int rho) { const int n = rho >> 4, i = rho & 15; return 8 * (i >> 2) + 4 * n + (i & 3); }

struct Unit { int pm, pn; };
struct Gemm { const bf16_t* A; const bf16_t* Bt; int M, N, K; };

struct StaticOrder {
    int nM, nN, nwg, G, c;
    __host__ __device__ void init(int M, int N, int G_, int c_) { nM = M / BM; nN = N / BM; nwg = nM * nN; G = G_; c = c_; }
    __host__ __device__ bool next(int i, Unit& u) const {
        const long L = (long)i * G + c; if (L >= nwg) return false;
        int wgid = (int)L; { const int q = nwg / NXCD, r = nwg % NXCD, xcd = wgid % NXCD, off = wgid / NXCD; wgid = (xcd < r ? xcd * (q + 1) : r * (q + 1) + (xcd - r) * q) + off; }
        const int nig = WGM * nN, gid = wgid / nig, fm = gid * WGM, gsz = (nM - fm) < WGM ? (nM - fm) : WGM;
        u.pm = fm + ((wgid % nig) % gsz); u.pn = (wgid % nig) / gsz; return true;
    }
    __device__ __forceinline__ void a_ready(const Unit&) const {}
    __device__ __forceinline__ void done(const Unit&) const {}
};

__device__ __forceinline__ unsigned cvt_pk_bf16(float lo, float hi) { unsigned r; asm volatile("v_cvt_pk_bf16_f32 %0, %1, %2" : "=v"(r) : "v"(lo), "v"(hi)); return r; }

template <int ACT> struct EpiBf16 {
    static constexpr bool PERM = true, AFTER_DRAIN = false;
    bf16_t* O; int ldc; int split_cols; size_t split_stride; float scale0;
    __device__ __forceinline__ void operator()(const f32x4 (&acc)[2][2][4][2], const Unit& u, int wr, int wc, int fr, int fq) const {
        const int row0 = u.pm * BM + wr * 64 + fr; int colt = u.pn * BM; bf16_t* base = O;
        float sc = 1.f; if (split_cols) { const int t = colt / split_cols; base += (size_t)t * split_stride; colt -= t * split_cols; if (t == 0) sc = scale0; }
        const int col0 = colt + wc * 32 + 8 * fq;
#pragma unroll
        for (int ai = 0; ai < 2; ++ai)
#pragma unroll
            for (int m = 0; m < 4; ++m) { bf16_t* rowp = base + (size_t)(row0 + ai * HALF + m * 16) * ldc + col0;
#pragma unroll
                for (int bj = 0; bj < 2; ++bj) { f32x4 v0 = acc[ai][bj][m][0], v1 = acc[ai][bj][m][1];
                    if (ACT == 2) {
#pragma unroll
                        for (int e = 0; e < 4; ++e) { const float a = v0[e] > 0.f ? v0[e] : 0.f, b = v1[e] > 0.f ? v1[e] : 0.f; v0[e] = a * a; v1[e] = b * b; } }
                    v0 = v0 * sc; v1 = v1 * sc; u32x4 w; w.x = cvt_pk_bf16(v0[0], v0[1]); w.y = cvt_pk_bf16(v0[2], v0[3]); w.z = cvt_pk_bf16(v1[0], v1[1]); w.w = cvt_pk_bf16(v1[2], v1[3]);
                    *(u32x4*)(rowp + bj * HALF) = w; } }
    }
};
struct EpiRes {
    static constexpr bool PERM = false, AFTER_DRAIN = false;
    const float* base; float* out; int ldc; const float* gate; int gate_bstride; int rows_per_batch;
    __device__ __forceinline__ void operator()(const f32x4 (&acc)[2][2][4][2], const Unit& u, int wr, int wc, int fr, int fq) const {
        const int row0 = u.pm * BM + wr * 64 + fr, col0 = u.pn * BM + wc * 32 + 4 * fq;
        const float* gp = gate + (size_t)((u.pm * BM) / rows_per_batch) * gate_bstride + col0;
        f32x4 gv[2][2];
#pragma unroll
        for (int bj = 0; bj < 2; ++bj)
#pragma unroll
            for (int n = 0; n < 2; ++n) gv[bj][n] = *(const f32x4*)(gp + bj * HALF + n * 16);
#pragma unroll
        for (int ai = 0; ai < 2; ++ai)
#pragma unroll
            for (int m = 0; m < 4; ++m) { const size_t off = (size_t)(row0 + ai * HALF + m * 16) * ldc + col0;
#pragma unroll
                for (int bj = 0; bj < 2; ++bj)
#pragma unroll
                    for (int n = 0; n < 2; ++n) { const f32x4 bs = *(const f32x4*)(base + off + bj * HALF + n * 16); *(f32x4*)(out + off + bj * HALF + n * 16) = bs + gv[bj][n] * acc[ai][bj][m][n]; }
                if (m & 1) asm volatile("" ::: "memory"); }
    }
};

template <class Epi, class Sched, bool ALIGN_EPI = false, bool SP2 = false>
__device__ __forceinline__ void gemm_phase(PG8_LAS unsigned char* lds, const Gemm g, const Sched& S, const Epi& E) {
    const int tid = threadIdx.x, wid = __builtin_amdgcn_readfirstlane(tid >> 6), lane = tid & 63, wr = wid >> 2, wc = wid & 3, fr = lane & 15, fq = lane >> 4;
    const int K = g.K, nt = K / BK;
    unsigned voffA[2], voffB[2];
#pragma unroll
    for (int i = 0; i < 2; ++i) { int R, C; stage_rc(tid * 16 + i * 8192, R, C); const int Rb = Epi::PERM ? ((R & ~31) + perm32(R & 31)) : R;
        voffA[i] = (unsigned)(R * K + C) * 2u; voffB[i] = (unsigned)(Rb * K + C) * 2u; }
    const size_t kstep = (size_t)(BK * 2);
    const size_t hstep = (size_t)HALF * K * 2;
    const size_t tstep = 2 * hstep;
    const unsigned ldsw = (unsigned)wid * 1024u;
    const int aoff = lds_byte(wr * 64 + fr, fq * 8), boff = lds_byte(wc * 32 + fr, fq * 8);
#define PG8_SA(b, h) (((b) * 2 + (h)) * HTB)
#define PG8_SB(b, h) ((4 + (b) * 2 + (h)) * HTB)
#define PG8_STAGE(bufoff, gbase, voff) do { _Pragma("unroll") for (int _i = 0; _i < 2; ++_i) \
        __builtin_amdgcn_global_load_lds((const unsigned*)((const char*)(gbase) + (voff)[_i]), (PG8_LAS unsigned*)(lds + (bufoff) + ldsw + _i * 8192), 16, 0, 0); } while (0)
#define PG8_LDA(dst, b, h) do { _Pragma("unroll") for (int m = 0; m < 4; ++m) _Pragma("unroll") for (int k = 0; k < 2; ++k) dst[m][k] = *(const PG8_LAS bf16x8*)(lds + PG8_SA(b, h) + aoff + m * 2048 + k * 1024); } while (0)
#define PG8_LDB(dst, b, h) do { _Pragma("unroll") for (int n = 0; n < 2; ++n) _Pragma("unroll") for (int k = 0; k < 2; ++k) dst[n][k] = *(const PG8_LAS bf16x8*)(lds + PG8_SB(b, h) + boff + n * 2048 + k * 1024); } while (0)
#define PG8_MMA(ai, bj, At, Bt) do { __builtin_amdgcn_s_setprio(1); _Pragma("unroll") for (int m = 0; m < 4; ++m) _Pragma("unroll") for (int n = 0; n < 2; ++n) _Pragma("unroll") for (int k = 0; k < 2; ++k) \
        acc[ai][bj][m][n] = __builtin_amdgcn_mfma_f32_16x16x32_bf16(Bt[n][k], At[m][k], acc[ai][bj][m][n], 0, 0, 0); __builtin_amdgcn_s_setprio(0); } while (0)
#define PG8_WAIT_V(n) asm volatile("s_waitcnt vmcnt(" #n ")" ::: "memory")
#define PG8_WAIT_L(n) asm volatile("s_waitcnt lgkmcnt(" #n ")" ::: "memory")
#define PG8_BAR __builtin_amdgcn_s_barrier()
#define PG8_SCHED __builtin_amdgcn_sched_barrier(0)
    Unit cur, nxt; int ui = 0;
    if (!S.next(0, cur)) return;
    f32x4 acc[2][2][4][2];
#pragma unroll
    for (int a = 0; a < 2; ++a)
#pragma unroll
        for (int b = 0; b < 2; ++b)
#pragma unroll
            for (int m = 0; m < 4; ++m)
#pragma unroll
                for (int n = 0; n < 2; ++n) acc[a][b][m][n] = (f32x4){0.f, 0.f, 0.f, 0.f};
    bf16x8 At[4][2], B0[2][2], B1[2][2];
    const char* cA = (const char*)g.A + (size_t)cur.pm * tstep; const char* cB = (const char*)g.Bt + (size_t)cur.pn * tstep;
    S.a_ready(cur);
    if constexpr (SP2) {
        PG8_STAGE(PG8_SB(0, 0), cB, voffB); PG8_STAGE(PG8_SB(0, 1), cB + hstep, voffB); PG8_STAGE(PG8_SA(0, 0), cA, voffA); PG8_STAGE(PG8_SA(0, 1), cA + hstep, voffA);
        if (wr == 1) PG8_BAR;
        PG8_WAIT_V(2); PG8_BAR;
        PG8_STAGE(PG8_SB(1, 0), cB + kstep, voffB); PG8_STAGE(PG8_SA(1, 0), cA + kstep, voffA); PG8_STAGE(PG8_SB(1, 1), cB + hstep + kstep, voffB);
        PG8_WAIT_V(6); PG8_BAR;
    } else {
        PG8_STAGE(PG8_SB(0, 0), cB, voffB); PG8_STAGE(PG8_SA(0, 0), cA, voffA); PG8_STAGE(PG8_SB(0, 1), cB + hstep, voffB); PG8_STAGE(PG8_SA(0, 1), cA + hstep, voffA);
        if (wr == 1) PG8_BAR;
        PG8_WAIT_V(4); PG8_BAR;
        PG8_STAGE(PG8_SB(1, 0), cB + kstep, voffB); PG8_STAGE(PG8_SA(1, 0), cA + kstep, voffA); PG8_STAGE(PG8_SB(1, 1), cB + hstep + kstep, voffB);
        PG8_WAIT_V(6); PG8_BAR;
    }
    for (;;) {
        const bool has_next = S.next(ui + 1, nxt);
        const char* nA = has_next ? (const char*)g.A + (size_t)nxt.pm * tstep : cA; const char* nB = has_next ? (const char*)g.Bt + (size_t)nxt.pn * tstep : cB;
        for (int t = 0; t < nt; t += 2) {
            const bool last = (t == nt - 2);
            const char* a1 = cA + (size_t)(t + 1) * kstep;
            const char* a2 = last ? nA : cA + (size_t)(t + 2) * kstep; const char* b2 = last ? nB : cB + (size_t)(t + 2) * kstep;
            const char* a3 = a2 + kstep; const char* b3 = b2 + kstep;
            if (last && has_next) S.a_ready(nxt);
            if constexpr (SP2) {
            PG8_LDB(B0, 0, 0); PG8_LDB(B1, 0, 1); PG8_SCHED; PG8_LDA(At, 0, 0); PG8_STAGE(PG8_SA(1, 1), a1 + hstep, voffA);
            PG8_WAIT_V(8); PG8_WAIT_L(0); PG8_BAR; PG8_MMA(0, 0, At, B0); PG8_MMA(0, 1, At, B1); PG8_BAR; PG8_SCHED;
            PG8_LDA(At, 0, 1); PG8_STAGE(PG8_SB(0, 0), b2, voffB); PG8_STAGE(PG8_SB(0, 1), b2 + hstep, voffB); PG8_STAGE(PG8_SA(0, 0), a2, voffA);
            PG8_WAIT_V(8); PG8_WAIT_L(0); PG8_BAR; PG8_MMA(1, 0, At, B0); PG8_MMA(1, 1, At, B1); PG8_BAR; PG8_SCHED;
            PG8_LDB(B0, 1, 0); PG8_LDB(B1, 1, 1); PG8_SCHED; PG8_LDA(At, 1, 0); PG8_STAGE(PG8_SA(0, 1), a2 + hstep, voffA);
            PG8_WAIT_V(8); PG8_WAIT_L(0); PG8_BAR; PG8_MMA(0, 0, At, B0); PG8_MMA(0, 1, At, B1); PG8_BAR; PG8_SCHED;
            PG8_LDA(At, 1, 1); PG8_STAGE(PG8_SB(1, 0), b3, voffB); PG8_STAGE(PG8_SB(1, 1), b3 + hstep, voffB); PG8_STAGE(PG8_SA(1, 0), a3, voffA);
            PG8_WAIT_V(8); PG8_WAIT_L(0); PG8_BAR; PG8_MMA(1, 0, At, B0); PG8_MMA(1, 1, At, B1); PG8_BAR; PG8_SCHED;
            } else {
            PG8_LDB(B0, 0, 0); PG8_SCHED; PG8_LDA(At, 0, 0); PG8_STAGE(PG8_SA(1, 1), a1 + hstep, voffA);
            PG8_WAIT_L(8); PG8_BAR; PG8_WAIT_L(0); PG8_MMA(0, 0, At, B0); PG8_BAR; PG8_SCHED;
            PG8_LDB(B1, 0, 1); PG8_STAGE(PG8_SB(0, 0), b2, voffB);
            PG8_BAR; PG8_WAIT_L(0); PG8_MMA(0, 1, At, B1); PG8_BAR;
            PG8_LDA(At, 0, 1); PG8_STAGE(PG8_SA(0, 0), a2, voffA);
            PG8_BAR; PG8_WAIT_L(0); PG8_MMA(1, 0, At, B0); PG8_BAR; PG8_SCHED;
            PG8_STAGE(PG8_SB(0, 1), b2 + hstep, voffB);
            PG8_WAIT_V(6); PG8_BAR; PG8_MMA(1, 1, At, B1); PG8_BAR;
            PG8_LDB(B0, 1, 0); PG8_SCHED; PG8_LDA(At, 1, 0); PG8_STAGE(PG8_SA(0, 1), a2 + hstep, voffA);
            PG8_WAIT_L(8); PG8_BAR; PG8_WAIT_L(0); PG8_MMA(0, 0, At, B0); PG8_BAR; PG8_SCHED;
            PG8_LDB(B1, 1, 1); PG8_STAGE(PG8_SB(1, 0), b3, voffB);
            PG8_BAR; PG8_WAIT_L(0); PG8_MMA(0, 1, At, B1); PG8_BAR;
            PG8_LDA(At, 1, 1); PG8_STAGE(PG8_SA(1, 0), a3, voffA);
            PG8_BAR; PG8_WAIT_L(0); PG8_MMA(1, 0, At, B0); PG8_BAR; PG8_SCHED;
            PG8_STAGE(PG8_SB(1, 1), b3 + hstep, voffB);
            PG8_WAIT_V(6); PG8_BAR; PG8_MMA(1, 1, At, B1); PG8_BAR;
            }
        }
        if constexpr (ALIGN_EPI) { if (wr == 0) PG8_BAR; }
        if constexpr (!Epi::AFTER_DRAIN) { E(acc, cur, wr, wc, fr, fq); S.done(cur); }
        if (!has_next) break;
#pragma unroll
        for (int a = 0; a < 2; ++a)
#pragma unroll
            for (int b = 0; b < 2; ++b)
#pragma unroll
                for (int m = 0; m < 4; ++m)
#pragma unroll
                    for (int n = 0; n < 2; ++n) acc[a][b][m][n] = (f32x4){0.f, 0.f, 0.f, 0.f};
        cur = nxt; cA = nA; cB = nB; ++ui;
        if constexpr (ALIGN_EPI) { if (wr == 1) PG8_BAR; }
    }
    PG8_WAIT_V(0);
    if constexpr (!ALIGN_EPI) { if (wr == 0) PG8_BAR; }
    PG8_BAR;
    if constexpr (Epi::AFTER_DRAIN) { E.fused(acc, cur, wr, wc, fr, fq, lds, wid, lane); S.done(cur); }
#undef PG8_SA
#undef PG8_SB
#undef PG8_STAGE
#undef PG8_LDA
#undef PG8_LDB
#undef PG8_MMA
#undef PG8_WAIT_V
#undef PG8_WAIT_L
#undef PG8_BAR
#undef PG8_SCHED
}
}
#define LAS __attribute__((address_space(3)))
#define GAS __attribute__((address_space(1)))
typedef unsigned short bf16;
typedef unsigned v4u __attribute__((ext_vector_type(4)));
typedef unsigned v2u __attribute__((ext_vector_type(2)));
typedef float f32x4 __attribute__((ext_vector_type(4)));
typedef float f32x16 __attribute__((ext_vector_type(16)));
typedef short bf16x8 __attribute__((ext_vector_type(8)));
typedef short s16x4 __attribute__((ext_vector_type(4)));
typedef GAS unsigned gu32;
#define RLX_AGENT __ATOMIC_RELAXED, __HIP_MEMORY_SCOPE_AGENT
#define LDS_WAIT() asm volatile("s_waitcnt lgkmcnt(0)" ::: "memory")
#define VM_WAIT() asm volatile("s_waitcnt vmcnt(0)" ::: "memory")
#define SBAR() __builtin_amdgcn_sched_barrier(0)
__device__ __forceinline__ unsigned cvtpk(float lo, float hi) { unsigned r; asm volatile("v_cvt_pk_bf16_f32 %0, %1, %2" : "=v"(r) : "v"(lo), "v"(hi)); return r; }
__device__ __forceinline__ float bf_lo(unsigned w) { return __builtin_bit_cast(float, w << 16); }
__device__ __forceinline__ float bf_hi(unsigned w) { return __builtin_bit_cast(float, w & 0xffff0000u); }
__device__ __forceinline__ float wave_sum(float v) {
#pragma unroll
    for (int o = 1; o < 64; o <<= 1) v += __shfl_xor(v, o);
    return v;
}
__device__ __forceinline__ int crow(int r, int hi) { return (r & 3) + 8 * (r >> 2) + 4 * hi; }

namespace sba {
constexpr int S = 2048, NH = 8, HD = 128, PITCH = 1024, QB = 256, KVB = 64;
constexpr int SHM_V = 16384, SHM_K = 16384;
#define KSWZ(row, colB) ((row) * 256 + ((colB) ^ (((row) & 7) << 4)))
__device__ __forceinline__ int v_st(int k, int c) { const int kk = (k & ~0xC) | ((k & 4) << 1) | ((k & 8) >> 1); return ((kk >> 3) * 4 + (c >> 5)) * 512 + ((kk & 7) * 32 + (c & 31)) * 2; }
__device__ __forceinline__ int v_rd_base(int lane) { return ((lane & 3) << 3) | (((lane >> 2) & 3) << 6) | (((lane >> 4) & 1) << 5) | (((lane >> 5) & 1) << 8); }
constexpr int v_rd_off(int d0, int ks, int half) { return d0 * 512 + ks * 4096 + half * 2048; }

__device__ __forceinline__ void qkt(f32x16& p0, f32x16& p1, const LAS char* Kb, int r32, int hi, const bf16x8* qr) {
    p0 = f32x16{}; p1 = f32x16{};
    const LAS char* kb[4];
#pragma unroll
    for (int dd = 0; dd < 4; ++dd) kb[dd] = Kb + KSWZ(r32, (dd * 16 + hi * 8) * 2);
#pragma unroll
    for (int d0 = 0; d0 < 8; ++d0) { const LAS char* a = kb[d0 & 3] + (d0 >> 2) * 128;
        const bf16x8 b0 = *(const LAS bf16x8*)a;
        const bf16x8 b1 = *(const LAS bf16x8*)(a + 32 * 256);
        p0 = __builtin_amdgcn_mfma_f32_32x32x16_bf16(b0, qr[d0], p0, 0, 0, 0);
        p1 = __builtin_amdgcn_mfma_f32_32x32x16_bf16(b1, qr[d0], p1, 0, 0, 0); }
}
__device__ __forceinline__ void pv_tile(f32x16* o, int vb, bf16x8 pa0, bf16x8 pa1, bf16x8 pa2, bf16x8 pa3) {
#define TRRD(dst, off) asm volatile("ds_read_b64_tr_b16 %0, %1 offset:%2" : "=&v"(dst) : "v"(vb), "i"(off) : "memory")
#define PV_D0(d0) do { s16x4 l0, l1, l2, l3, h0, h1, h2, h3; constexpr int b_ = v_rd_off(d0, 0, 0); \
        TRRD(l0, b_); TRRD(h0, b_ + 2048); TRRD(l1, b_ + 4096); TRRD(h1, b_ + 6144); TRRD(l2, b_ + 8192); TRRD(h2, b_ + 10240); TRRD(l3, b_ + 12288); TRRD(h3, b_ + 14336); \
        asm volatile("s_waitcnt lgkmcnt(0)" ::: "memory"); SBAR(); \
        o[d0] = __builtin_amdgcn_mfma_f32_32x32x16_bf16(pa0, (bf16x8){l0[0], l0[1], l0[2], l0[3], h0[0], h0[1], h0[2], h0[3]}, o[d0], 0, 0, 0); \
        o[d0] = __builtin_amdgcn_mfma_f32_32x32x16_bf16(pa1, (bf16x8){l1[0], l1[1], l1[2], l1[3], h1[0], h1[1], h1[2], h1[3]}, o[d0], 0, 0, 0); \
        o[d0] = __builtin_amdgcn_mfma_f32_32x32x16_bf16(pa2, (bf16x8){l2[0], l2[1], l2[2], l2[3], h2[0], h2[1], h2[2], h2[3]}, o[d0], 0, 0, 0); \
        o[d0] = __builtin_amdgcn_mfma_f32_32x32x16_bf16(pa3, (bf16x8){l3[0], l3[1], l3[2], l3[3], h3[0], h3[1], h3[2], h3[3]}, o[d0], 0, 0, 0); } while (0)
    PV_D0(0); PV_D0(1); PV_D0(2); PV_D0(3);
#undef PV_D0
#undef TRRD
}
__device__ __forceinline__ void sb_split(f32x16& p, bf16x8& f0, bf16x8& f1, float& ls_row0) {
    float ls[16];
#pragma unroll
    for (int r = 0; r < 16; ++r) { const float z = p[r]; const float e = __builtin_amdgcn_exp2f(-__builtin_fabsf(z)); const float l = __builtin_amdgcn_logf(1.0f + e);
        const float lb = __builtin_fminf(z, 0.f) - l; ls[r] = lb - z; p[r] = lb; }
    ls_row0 = ls[0];
    v4u a = {cvtpk(ls[0], ls[1]), cvtpk(ls[2], ls[3]), cvtpk(ls[4], ls[5]), cvtpk(ls[6], ls[7])};
    v4u b = {cvtpk(ls[8], ls[9]), cvtpk(ls[10], ls[11]), cvtpk(ls[12], ls[13]), cvtpk(ls[14], ls[15])};
    f0 = __builtin_bit_cast(bf16x8, a); f1 = __builtin_bit_cast(bf16x8, b);
}
#define PK4(P, B_, OUT) do { const unsigned a0 = cvtpk(P[B_+0], P[B_+1]), a1 = cvtpk(P[B_+2], P[B_+3]); \
        const unsigned b0 = cvtpk(P[B_+4], P[B_+5]), b1 = cvtpk(P[B_+6], P[B_+7]); \
        auto r0 = __builtin_amdgcn_permlane32_swap(a0, b0, false, false); auto r1 = __builtin_amdgcn_permlane32_swap(a1, b1, false, false); \
        v4u w = {r0[0], r1[0], r0[1], r1[1]}; OUT = __builtin_bit_cast(bf16x8, w); } while (0)

__device__ __forceinline__ void attn_unit(int b, int h, int qb, const bf16* __restrict__ Q, const bf16* __restrict__ K, const bf16* __restrict__ V, float* __restrict__ O, LAS char* lds) {
    const int tid = threadIdx.x, wid = __builtin_amdgcn_readfirstlane(tid >> 6), lane = tid & 63, r32 = lane & 31, hi = lane >> 5;
    const size_t rowbase = (size_t)b * S; const int q0 = qb * QB, qlo = q0 + wid * 32;
    const int NT = (q0 + QB) / KVB;
    LAS char* V_lds = lds; LAS char* K_lds = lds + 2 * SHM_V;
    const int sr = tid >> 4, sc = (tid & 15) * 8, vst0 = v_st(sr, sc), vst1 = v_st(32 + sr, sc), kws = KSWZ(sr, sc * 2);
    const int vb0 = (int)(unsigned)(uintptr_t)V_lds + v_rd_base(lane);
    const bf16* Kh = K + rowbase * PITCH + h * HD + sc; const bf16* Vh = V + rowbase * PITCH + h * HD + sc;
    bf16x8 qr[8];
    { const bf16* Qw = Q + (rowbase + qlo + r32) * PITCH + h * HD + hi * 8;
#pragma unroll
      for (int d0 = 0; d0 < 8; ++d0) qr[d0] = *(const bf16x8*)(Qw + d0 * 16); }
    bf16x8 tri0, tri1, ones;
#pragma unroll
    for (int jj = 0; jj < 8; ++jj) { const int k0 = 8 * (jj >> 2) + 4 * hi + (jj & 3); tri0[jj] = (k0 > r32) ? (short)0x3F80 : (short)0; tri1[jj] = (16 + k0 > r32) ? (short)0x3F80 : (short)0; ones[jj] = (short)0x3F80; }
    f32x16 o[4]; o[0] = f32x16{}; o[1] = f32x16{}; o[2] = f32x16{}; o[3] = f32x16{};
    float carry = 0.f;
    bf16x8 st_k0, st_k1, st_v0, st_v1;
#define SLOAD(kb_) do { st_k0 = *(const bf16x8*)(Kh + (size_t)((kb_) + sr) * PITCH); st_k1 = *(const bf16x8*)(Kh + (size_t)((kb_) + 32 + sr) * PITCH); \
                        st_v0 = *(const bf16x8*)(Vh + (size_t)((kb_) + sr) * PITCH); st_v1 = *(const bf16x8*)(Vh + (size_t)((kb_) + 32 + sr) * PITCH); } while (0)
#define SWRITE(bf) do { *(LAS bf16x8*)(K_lds + (bf) * SHM_K + kws) = st_k0; *(LAS bf16x8*)(K_lds + (bf) * SHM_K + kws + 32 * 256) = st_k1; \
                        *(LAS bf16x8*)(V_lds + (bf) * SHM_V + vst0) = st_v0; *(LAS bf16x8*)(V_lds + (bf) * SHM_V + vst1) = st_v1; } while (0)
    SLOAD((NT - 1) * KVB); SWRITE(0);
    __syncthreads();
    for (int it = 0; it < NT; ++it) {
        const int kb = (NT - 1 - it) * KVB, buf = it & 1;
        if (it + 1 < NT) SLOAD(kb - KVB);
        if (kb <= qlo) {
            f32x16 p0, p1;
            qkt(p0, p1, K_lds + buf * SHM_K, r32, hi, qr);
            if (kb + KVB - 1 >= qlo) {
                const int row = qlo + r32;
#pragma unroll
                for (int r = 0; r < 16; ++r) { const int key = kb + crow(r, hi); if (key >= row) p0[r] = -1e30f; if (key + 32 >= row) p1[r] = -1e30f; }
            }
            bf16x8 l00, l01, l10, l11; float ls00, ls10;
            sb_split(p0, l00, l01, ls00); sb_split(p1, l10, l11, ls10);
            f32x16 a1 = __builtin_amdgcn_mfma_f32_32x32x16_bf16(tri0, l10, f32x16{}, 0, 0, 0);
            a1 = __builtin_amdgcn_mfma_f32_32x32x16_bf16(tri1, l11, a1, 0, 0, 0);
            f32x16 a0 = __builtin_amdgcn_mfma_f32_32x32x16_bf16(tri0, l00, f32x16{}, 0, 0, 0);
            a0 = __builtin_amdgcn_mfma_f32_32x32x16_bf16(tri1, l01, a0, 0, 0, 0);
            a0 = __builtin_amdgcn_mfma_f32_32x32x16_bf16(ones, l10, a0, 0, 0, 0);
            a0 = __builtin_amdgcn_mfma_f32_32x32x16_bf16(ones, l11, a0, 0, 0, 0);
            float tot = a0[0] + ls00;
            { auto rr = __builtin_amdgcn_permlane32_swap(__float_as_uint(tot), __float_as_uint(tot), false, false); tot = __uint_as_float(rr[0]); }
#pragma unroll
            for (int r = 0; r < 16; ++r) { p0[r] = __builtin_amdgcn_exp2f((p0[r] + carry) + a0[r]); p1[r] = __builtin_amdgcn_exp2f((p1[r] + carry) + a1[r]); }
            carry += tot;
            bf16x8 pa0, pa1, pa2, pa3;
            PK4(p0, 0, pa0); PK4(p0, 8, pa1); PK4(p1, 0, pa2); PK4(p1, 8, pa3);
            pv_tile(o, vb0 + buf * SHM_V, pa0, pa1, pa2, pa3);
        }
        if (it + 1 < NT) SWRITE(buf ^ 1);
        __syncthreads();
    }
#undef SLOAD
#undef SWRITE
    float* Ow = O + (rowbase + qlo) * PITCH + h * HD + r32;
#pragma unroll
    for (int r = 0; r < 16; ++r) { const int orow = crow(r, hi);
#pragma unroll
        for (int d0 = 0; d0 < 4; ++d0) Ow[(size_t)orow * PITCH + d0 * 32] = o[d0][r]; }
}
#undef PK4
}
namespace lru {
constexpr int S = 2048, LW = 1024, CH = 128, TK = 128;
constexpr int XCF_OFF = 0, AL_OFF = 65536, XCB_OFF = 65536;
__device__ __forceinline__ void lru_unit(int b, int hh, int ck, const bf16* __restrict__ XR, const float* __restrict__ wconv, const float* __restrict__ bconv, const bf16* __restrict__ WGT,
                                         const float* __restrict__ b_a, const float* __restrict__ b_x, const float* __restrict__ lam, float* __restrict__ HLOC, float* __restrict__ ACUM,
                                         LAS char* lds, LAS float* sum  ) {
    const int tid = threadIdx.x, wid = __builtin_amdgcn_readfirstlane(tid >> 6), lane = tid & 63, r32 = lane & 31, hi = lane >> 5;
    const size_t R0 = (size_t)b * S + (size_t)ck * TK; const int C0 = hh * CH;
    LAS float* XCF = (LAS float*)(lds + XCF_OFF); LAS float* AL = (LAS float*)(lds + AL_OFF); LAS char* XCB = lds + XCB_OFF;
    {
        const int cg = tid & 15, ts = tid >> 4, c8 = C0 + 8 * cg;
        float xr[7][8];
#pragma unroll
        for (int i = 0; i < 7; ++i) { const int tl = ck * TK + 4 * ts - 3 + i;
            v4u raw = {0u, 0u, 0u, 0u};
            if (tl >= 0) raw = *(const v4u*)(XR + (R0 + 4 * ts - 3 + i) * LW + c8);
#pragma unroll
            for (int e = 0; e < 4; ++e) { xr[i][2 * e] = bf_lo(raw[e]); xr[i][2 * e + 1] = bf_hi(raw[e]); } }
        float w[4][8], bb[8];
#pragma unroll
        for (int j = 0; j < 4; ++j) { const f32x4 w0 = *(const f32x4*)(wconv + j * LW + c8), w1 = *(const f32x4*)(wconv + j * LW + c8 + 4);
#pragma unroll
            for (int e = 0; e < 4; ++e) { w[j][e] = w0[e]; w[j][4 + e] = w1[e]; } }
        { const f32x4 b0 = *(const f32x4*)(bconv + c8), b1 = *(const f32x4*)(bconv + c8 + 4);
#pragma unroll
          for (int e = 0; e < 4; ++e) { bb[e] = b0[e]; bb[4 + e] = b1[e]; } }
#pragma unroll
        for (int tt = 0; tt < 4; ++tt) { float xc[8];
#pragma unroll
            for (int e = 0; e < 8; ++e) { float a = bb[e];
#pragma unroll
                for (int j = 0; j < 4; ++j) a += w[j][e] * xr[tt + j][e];
                xc[e] = a; }
            const int row = 4 * ts + tt;
            *(LAS f32x4*)(XCF + row * CH + 8 * cg) = (f32x4){xc[0], xc[1], xc[2], xc[3]};
            *(LAS f32x4*)(XCF + row * CH + 8 * cg + 4) = (f32x4){xc[4], xc[5], xc[6], xc[7]};
            v4u pk = {cvtpk(xc[0], xc[1]), cvtpk(xc[2], xc[3]), cvtpk(xc[4], xc[5]), cvtpk(xc[6], xc[7])};
            *(LAS v4u*)(XCB + row * 256 + ((cg * 16) ^ ((row & 7) << 4))) = pk; }
    }
    __syncthreads();
    const int tb = wid & 3, dh = wid >> 2;
    f32x16 acc[2][2]; acc[0][0] = f32x16{}; acc[0][1] = f32x16{}; acc[1][0] = f32x16{}; acc[1][1] = f32x16{};
    {
        const int arow = tb * 32 + r32;
        const LAS char* ab[4];
#pragma unroll
        for (int dd = 0; dd < 4; ++dd) ab[dd] = XCB + arow * 256 + (((2 * dd + hi) * 16) ^ ((arow & 7) << 4));
        const bf16* wb = WGT + ((size_t)(hh * 2) * CH + dh * 64 + r32) * CH + hi * 8;
#pragma unroll
        for (int s = 0; s < 8; ++s) { const bf16x8 af = *(const LAS bf16x8*)(ab[s & 3] + (s >> 2) * 128);
#pragma unroll
            for (int g = 0; g < 2; ++g)
#pragma unroll
                for (int db = 0; db < 2; ++db) { const bf16x8 bfr = *(const bf16x8*)(wb + (size_t)(g * CH + db * 32) * CH + s * 16);
                    acc[g][db] = __builtin_amdgcn_mfma_f32_32x32x16_bf16(af, bfr, acc[g][db], 0, 0, 0); } }
    }
    __syncthreads();
#pragma unroll
    for (int db = 0; db < 2; ++db) { const int dl = dh * 64 + db * 32 + r32, cgl = C0 + dl;
        const float ba = b_a[cgl], bx = b_x[cgl], spl = log1pf(__expf(-lam[cgl]));
#pragma unroll
        for (int r = 0; r < 16; ++r) { const int t = tb * 32 + crow(r, hi);
            const float ga = acc[0][db][r] + ba, gx = acc[1][db][r] + bx;
            const float rg = 1.f / (1.f + __expf(-ga)), ig = 1.f / (1.f + __expf(-gx));
            const float la = -8.f * rg * spl, a = __expf(la), y = 2.f * la;
            const float om = (y > -0.05f) ? -y * (1.f + y * (0.5f + y * (0.16666667f + y * 0.041666668f))) : 1.f - __expf(y);
            const float u = sqrtf(om) * (ig * XCF[t * CH + dl]);
            AL[t * CH + dl] = a; XCF[t * CH + dl] = u; } }
    __syncthreads();
    {
        const int d = tid & 127, seg = tid >> 7;
        float h = 0.f, P = 1.f;
        for (int t = seg * 32; t < seg * 32 + 32; ++t) { const float a = AL[t * CH + d], u = XCF[t * CH + d]; h = a * h + u; P *= a; XCF[t * CH + d] = h; AL[t * CH + d] = P; }
        sum[(seg * CH + d) * 2] = P; sum[(seg * CH + d) * 2 + 1] = h;
        __syncthreads();
        float Hin = 0.f, Ain = 1.f;
        for (int s2 = 0; s2 < seg; ++s2) { const float Ps = sum[(s2 * CH + d) * 2], hs = sum[(s2 * CH + d) * 2 + 1]; Hin = Ps * Hin + hs; Ain *= Ps; }
        for (int t = seg * 32; t < seg * 32 + 32; ++t) { const float Pl = AL[t * CH + d], hl = XCF[t * CH + d];
            HLOC[(R0 + t) * LW + C0 + d] = hl + Pl * Hin; ACUM[(R0 + t) * LW + C0 + d] = Pl * Ain; }
    }
    __syncthreads();
}
}
constexpr int NWAVES = 8;
constexpr int BATCH = 4, SEQ = 2048, DM = 2048, M = BATCH * SEQ, AW = 1024, LW = 1024, NHEAD = 8, HD = 128, INC = 5120, FF = 8192, NMOD = 6, MODW = NMOD * DM;
constexpr float EPS = 1e-6f;
constexpr float QSCALE = 0.08838834764831845f * 1.4426950408889634f;
constexpr int KSPLIT = 16, KCH = DM / KSPLIT, NCG = MODW / 256;
#ifndef MK_N_LAUNCHES
#define MK_N_LAUNCHES 1
#endif
constexpr int NPH = 10;
constexpr int N_LAUNCHES = MK_N_LAUNCHES;

constexpr size_t MiB = 1u << 20;
constexpr size_t WS_CTL = 0, CTL_ZERO_BYTES = 64 * 1024;
constexpr size_t WS_MOD = 1 * MiB;
constexpr size_t WS_MODP = 2 * MiB;
constexpr size_t WS_WGT = 5 * MiB;
constexpr size_t WS_WIN = 6 * MiB, WS_WOUT = 26 * MiB, WS_WMI = 34 * MiB, WS_WMO = 66 * MiB;
constexpr size_t WS_XN = 98 * MiB;
constexpr size_t WS_Q = 130 * MiB, WS_SPLIT = 16 * MiB;
constexpr size_t WS_HLOC = 226 * MiB, WS_ACUM = 258 * MiB, WS_OATT = 290 * MiB;
constexpr size_t WS_HID = 130 * MiB;
constexpr size_t WS_END = 322 * MiB;
constexpr int CW_BAR = 1024;
constexpr int RING_BYTES = 131072;
constexpr int LDSCTL_OFF = RING_BYTES, MISC_OFF = LDSCTL_OFF + 320, SUM_OFF = RING_BYTES + 1024, MODL_OFF = 0;
constexpr int LDS_BYTES = 147456;
static_assert(SUM_OFF + 4096 <= LDS_BYTES, "LDS map");

#define XB_TMO      128
#define XB_XCNT(j)  (256  + 64 * (j))
#define XB_XSUB(j)  (1280 + 64 * (j))
#define XB_XGEN(j)  (2304 + 64 * (j))
#define XB_TOP      3328
#define XB_TOPGEN   3392
#define XCD_BAR_WORDS 3456
#define XB_SPIN_CAP (1u << 18)

__device__ __forceinline__ unsigned xb_ld(unsigned* p)              { return __hip_atomic_load(p, __ATOMIC_RELAXED, __HIP_MEMORY_SCOPE_AGENT); }
__device__ __forceinline__ unsigned xb_add(unsigned* p, unsigned v) { return __hip_atomic_fetch_add(p, v, __ATOMIC_RELAXED, __HIP_MEMORY_SCOPE_AGENT); }
__device__ __forceinline__ unsigned xb_xcc_id() { return (unsigned)__builtin_amdgcn_s_getreg((3 << 11) | 20) & 0xFu; }
#define XB_SPIN(cond, bar) do { unsigned _sp = 0; while (cond) { __builtin_amdgcn_s_sleep(1); \
    if ((++_sp & 255u) == 0u) { if (xb_ld(&(bar)[XB_TMO])) break; if (_sp > XB_SPIN_CAP) { atomicAdd(&(bar)[XB_TMO], 1u); break; } } } } while (0)

struct XcdBarrier {
    unsigned* bar; unsigned x;
    volatile LAS unsigned* st;
};

__device__ __forceinline__ XcdBarrier xcd_barrier_post(unsigned* bar, volatile LAS unsigned* st) {
    XcdBarrier b; b.bar = bar; b.x = xb_xcc_id(); b.st = st;
    if (threadIdx.x == 0) (void)xb_add(&bar[XB_XCNT(b.x)], 1u);
    return b;
}
__device__ __forceinline__ void xcd_barrier_complete(unsigned* bar, unsigned x, unsigned& nloc, unsigned& nx) {
    const unsigned G = gridDim.x * gridDim.y * gridDim.z;
    unsigned sum, cnt, mine, sp = 0u;
    for (;;) {
        sum = 0u; cnt = 0u; mine = 0u;
#pragma unroll
        for (unsigned j = 0; j < 16; ++j) { const unsigned c = xb_ld(&bar[XB_XCNT(j)]); sum += c; cnt += (c > 0u) ? 1u : 0u; mine = (j == x) ? c : mine; }
        if (sum == G) break;
        __builtin_amdgcn_s_sleep(1);
        if ((++sp & 255u) == 0u) { if (xb_ld(&bar[XB_TMO])) break; if (sp > XB_SPIN_CAP) { atomicAdd(&bar[XB_TMO], 1u); break; } }
    }
    nloc = mine > 0u ? mine : 1u; nx = cnt > 0u ? cnt : 1u;
}

__device__ __forceinline__ void xcd_barrier(const XcdBarrier& b) {
    asm volatile("s_waitcnt vmcnt(0)" ::: "memory");
    __syncthreads();
    if (threadIdx.x == 0) {
        unsigned* bar = b.bar;
        __builtin_amdgcn_s_waitcnt(0);
        unsigned nloc = b.st[0], nx = b.st[1];
        if (nloc == 0u) { xcd_barrier_complete(bar, b.x, nloc, nx); b.st[0] = nloc; b.st[1] = nx; }
        const unsigned old = xb_add(&bar[XB_XSUB(b.x)], 1u);
        const unsigned gen = old / nloc;
        if (old + 1u == (gen + 1u) * nloc) {
            __builtin_amdgcn_fence(__ATOMIC_RELEASE, "agent");
            asm volatile("s_waitcnt vmcnt(0)" ::: "memory");
            const unsigned og = xb_add(&bar[XB_TOP], 1u);
            const unsigned tg = og / nx;
            if (og + 1u == (tg + 1u) * nx) xb_add(&bar[XB_TOPGEN], 1u);
            else XB_SPIN(xb_ld(&bar[XB_TOPGEN]) == tg, bar);
            __builtin_amdgcn_fence(__ATOMIC_ACQUIRE, "agent");
            xb_add(&bar[XB_XGEN(b.x)], 1u);
            asm volatile("s_waitcnt vmcnt(0)" ::: "memory");
        } else {
            XB_SPIN(xb_ld(&bar[XB_XGEN(b.x)]) == gen, bar);
            __builtin_amdgcn_fence(__ATOMIC_ACQUIRE, "agent");
            asm volatile("s_waitcnt vmcnt(0)" ::: "memory");
        }
    }
    __syncthreads();
}

__device__ __forceinline__ unsigned f2bf(float f) { unsigned u = __builtin_bit_cast(unsigned, f); return (u + 0x7fffu + ((u >> 16) & 1u)) >> 16; }
__device__ __forceinline__ unsigned pk2(float lo, float hi) { return f2bf(lo) | (f2bf(hi) << 16); }
__device__ __forceinline__ void p0_transpose_item(const float* W, int K, int N, bf16* WT, LAS float* scr, int item, int lane) {
    const int nblk = N / 32, kb = item / nblk, nb = item % nblk, k0 = 64 * kb, n0 = 32 * nb;
#pragma unroll 8
    for (int i = 0; i < 32; ++i) { const int kk = 2 * i + (lane >> 5); scr[kk * 33 + (lane & 31)] = W[(size_t)(k0 + kk) * N + n0 + (lane & 31)]; }
    LDS_WAIT(); asm volatile("" ::: "memory");
    const int c = lane & 7;
#pragma unroll
    for (int j = 0; j < 4; ++j) { const int n = (lane >> 3) + 8 * j; const LAS float* s = scr + (8 * c) * 33 + n;
        v4u o; o.x = pk2(s[0 * 33], s[1 * 33]); o.y = pk2(s[2 * 33], s[3 * 33]); o.z = pk2(s[4 * 33], s[5 * 33]); o.w = pk2(s[6 * 33], s[7 * 33]);
        *(GAS v4u*)(WT + (size_t)(n0 + n) * K + k0 + 8 * c) = o; }
    LDS_WAIT(); asm volatile("" ::: "memory");
}
__device__ __forceinline__ void p0_ada_task(const float* cvec, const float* w_ada, float* modp, LAS float* scr, int task, int lane) {
    const int cg = task % NCG, ks = task / NCG;
#pragma unroll
    for (int i = 0; i < 2; ++i)
#pragma unroll
        for (int b = 0; b < BATCH; ++b) { const int k = lane + 64 * i; const float v = cvec[b * DM + ks * KCH + k]; scr[b * KCH + k] = v / (1.f + __expf(-v)); }
    LDS_WAIT(); asm volatile("" ::: "memory");
    f32x4 acc[BATCH]; for (int b = 0; b < BATCH; ++b) acc[b] = (f32x4){0.f, 0.f, 0.f, 0.f};
    const float* wp = w_ada + (size_t)(ks * KCH) * MODW + cg * 256 + lane * 4;
#pragma unroll 8
    for (int k = 0; k < KCH; ++k) { const f32x4 wv = *(const f32x4*)(wp + (size_t)k * MODW);
#pragma unroll
        for (int b = 0; b < BATCH; ++b) acc[b] += wv * scr[b * KCH + k]; }
#pragma unroll
    for (int b = 0; b < BATCH; ++b) *(f32x4*)(modp + (size_t)(ks * BATCH + b) * MODW + cg * 256 + lane * 4) = acc[b];
    LDS_WAIT(); asm volatile("" ::: "memory");
}
__device__ __forceinline__ void norm_mod_row(const float* xrow, const float* g, const LAS float* sh, const LAS float* sc, bf16* orow, int lane) {
    f32x4 v[8]; float s = 0.f;
#pragma unroll
    for (int j = 0; j < 8; ++j) { v[j] = *(const f32x4*)(xrow + 4 * lane + 256 * j); s += (v[j].x * v[j].x + v[j].y * v[j].y) + (v[j].z * v[j].z + v[j].w * v[j].w); }
    const float rs = 1.0f / sqrtf(wave_sum(s) * (1.f / DM) + EPS);
#pragma unroll
    for (int j = 0; j < 8; ++j) { const int c0 = 4 * lane + 256 * j; const f32x4 gv = *(const f32x4*)(g + c0); const f32x4 shv = *(const LAS f32x4*)(sh + c0), scv = *(const LAS f32x4*)(sc + c0);
        const f32x4 y = (v[j] * rs) * gv * (scv + 1.0f) + shv;
        v2u o; o.x = cvtpk(y.x, y.y); o.y = cvtpk(y.z, y.w); *(v2u*)(orow + c0) = o; }
}
__device__ __forceinline__ float gelu_tanh(float x) { const float u = 0.7978845608028654f * (x + 0.044715f * x * x * x); const float e = __expf(2.f * u); const float th = 1.f - 2.f / (e + 1.f); return 0.5f * x * (1.f + th); }

struct Args { const float* in[20]; float* out; unsigned char* ws; int ph_lo, ph_hi, li, pad; };
__global__ void __launch_bounds__(NWAVES * 64, 2) mega_fwd(Args args) {
    extern __shared__ __attribute__((aligned(16))) unsigned char lds_raw[];
    LAS unsigned char* lds = (LAS unsigned char*)lds_raw;
    volatile LAS unsigned* MISC = (volatile LAS unsigned*)(lds + MISC_OFF);
    const int tid = threadIdx.x, lane = tid & 63, wave = __builtin_amdgcn_readfirstlane(tid >> 6);
    const int G = gridDim.x; const int vcu = (G % 8 == 0) ? ((int)blockIdx.x % 8) * (G / 8) + (int)blockIdx.x / 8 : (int)blockIdx.x;
    unsigned char* ws = args.ws;
    const float* x = args.in[0]; const float* cvec = args.in[1]; const float* w_ada = args.in[2]; const float* b_ada = args.in[3]; const float* g_mix = args.in[4]; const float* w_in = args.in[5];
    const float* w_conv = args.in[6]; const float* b_conv = args.in[7]; const float* w_rg_a = args.in[8]; const float* b_rg_a = args.in[9]; const float* w_rg_x = args.in[10]; const float* b_rg_x = args.in[11];
    const float* lam = args.in[12]; const float* g_attn = args.in[13]; const float* g_lru = args.in[14]; const float* w_out = args.in[15]; const float* g_mlp = args.in[16];
    const float* w_mi = args.in[17]; const float* w_mo = args.in[18]; const float* g_fin = args.in[19]; float* out = args.out;
    float* MOD = (float*)(ws + WS_MOD); float* MODP = (float*)(ws + WS_MODP); bf16* WGT = (bf16*)(ws + WS_WGT);
    bf16* WIN = (bf16*)(ws + WS_WIN); bf16* WOUT = (bf16*)(ws + WS_WOUT); bf16* WMI = (bf16*)(ws + WS_WMI); bf16* WMO = (bf16*)(ws + WS_WMO);
    bf16* XN = (bf16*)(ws + WS_XN); bf16* QB = (bf16*)(ws + WS_Q); bf16* KB = (bf16*)(ws + WS_Q + WS_SPLIT); bf16* VB = (bf16*)(ws + WS_Q + 2 * WS_SPLIT);
    bf16* XR = (bf16*)(ws + WS_Q + 3 * WS_SPLIT); bf16* XG = (bf16*)(ws + WS_Q + 4 * WS_SPLIT);
    float* HLOC = (float*)(ws + WS_HLOC); float* ACUM = (float*)(ws + WS_ACUM); float* OATT = (float*)(ws + WS_OATT); bf16* HID = (bf16*)(ws + WS_HID);

    for (int u = tid; u < (LDS_BYTES - LDSCTL_OFF) / 4; u += NWAVES * 64) ((LAS unsigned*)(lds + LDSCTL_OFF))[u] = 0u;
    __syncthreads();
    XcdBarrier bar; bar.bar = (unsigned*)(ws + WS_CTL) + CW_BAR; bar.x = 0; bar.st = nullptr;
    if (N_LAUNCHES == 1) bar = xcd_barrier_post((unsigned*)(ws + WS_CTL) + CW_BAR, MISC + 8);
    const int lo = args.ph_lo, hi_ph = args.ph_hi;
#define IN(k) (lo <= (k) && (k) < hi_ph)
#define SEAM(k) do { if (IN(k) && IN((k) + 1)) xcd_barrier(bar); } while (0)

    if (IN(0)) {
        LAS float* scr = (LAS float*)(lds + wave * 16384);
        if (wave < 3) { p0_ada_task(cvec, w_ada, MODP, scr, vcu * 3 + wave, lane); }
        else {
            const int tw = vcu * 5 + (wave - 3), NTW = G * 5;
            constexpr int I_IN = (DM / 64) * (INC / 32), I_OUT = (DM / 64) * (DM / 32), I_MI = (DM / 64) * (FF / 32), I_MO = (FF / 64) * (DM / 32), I_G = 16 * 8;
            constexpr int NITEMS = I_IN + I_OUT + I_MI + I_MO + I_G;
            for (int it = tw; it < NITEMS; it += NTW) {
                int r = it;
                if (r < I_IN) { p0_transpose_item(w_in, DM, INC, WIN, scr, r, lane); continue; } r -= I_IN;
                if (r < I_OUT) { p0_transpose_item(w_out, DM, DM, WOUT, scr, r, lane); continue; } r -= I_OUT;
                if (r < I_MI) { p0_transpose_item(w_mi, DM, FF, WMI, scr, r, lane); continue; } r -= I_MI;
                if (r < I_MO) { p0_transpose_item(w_mo, FF, DM, WMO, scr, r, lane); continue; } r -= I_MO;
                { const int mat = r >> 3, hh = mat >> 1, g = mat & 1;
                  p0_transpose_item((g ? w_rg_x : w_rg_a) + (size_t)hh * 16384, 128, 128, WGT + (size_t)mat * 16384, scr, r & 7, lane); }
            }
        }
    }
    SEAM(0);
    if (IN(1)) {
        LAS float* modl = (LAS float*)(lds + MODL_OFF);
        const int b = vcu / (G / BATCH);
        for (int n = tid; n < 2 * DM; n += NWAVES * 64) { float s = b_ada[n];
#pragma unroll
            for (int ks = 0; ks < KSPLIT; ++ks) s += MODP[(size_t)(ks * BATCH + b) * MODW + n];
            modl[n] = s; }
        for (int n = vcu * (BATCH * MODW / G) + tid; n < (vcu + 1) * (BATCH * MODW / G); n += NWAVES * 64) { const int bb = n / MODW, nn = n % MODW; float s = b_ada[nn];
#pragma unroll
            for (int ks = 0; ks < KSPLIT; ++ks) s += MODP[(size_t)(ks * BATCH + bb) * MODW + nn];
            MOD[n] = s; }
        __syncthreads();
        const int rpw = M / (G * NWAVES);
        for (int j = 0; j < rpw; ++j) { const size_t row = (size_t)(vcu * NWAVES + wave) * rpw + j;
            norm_mod_row(x + row * DM, g_mix, modl, modl + DM, XN + row * DM, lane); }
        __syncthreads();
    }
    SEAM(1);
    if (IN(2)) {
        pg8::Gemm g{XN, WIN, M, INC, DM}; pg8::StaticOrder S; S.init(M, INC, G, (int)blockIdx.x);
        pg8::EpiBf16<0> E{QB, AW, AW, (size_t)(WS_SPLIT / 2), QSCALE};
        pg8::gemm_phase<pg8::EpiBf16<0>, pg8::StaticOrder, true, true>(lds, g, S, E);
    }
    SEAM(2);
    if (IN(3)) {
        const int grp = vcu >> 3, qb = vcu & 7;
        if (grp < BATCH * NHEAD) sba::attn_unit(grp / NHEAD, grp % NHEAD, qb, QB, KB, VB, OATT, (LAS char*)lds);
        const int k_lo = qb == 0 ? 0 : qb == 1 ? 5 : qb == 2 ? 9 : qb == 3 ? 12 : qb == 4 ? 14 : qb == 5 ? 15 : 16;
        const int k_hi = qb == 0 ? 5 : qb == 1 ? 9 : qb == 2 ? 12 : qb == 3 ? 14 : qb == 4 ? 15 : 16;
        if (grp < BATCH * NHEAD)
            for (int k = k_lo; k < k_hi; ++k) { const int u = grp * 16 + k, ck = u & 15, hh = (u >> 4) & 7, b = u >> 7;
                lru::lru_unit(b, hh, ck, XR, w_conv, b_conv, WGT, b_rg_a, b_rg_x, lam, HLOC, ACUM, (LAS char*)lds, (LAS float*)(lds + SUM_OFF)); }
    }
    SEAM(3);
    if (IN(4)) {
        LAS float* hin = (LAS float*)lds;
        const int rows_wg = M / G, r0 = vcu * rows_wg, b = r0 / SEQ, ck = (r0 % SEQ) / lru::TK;
        for (int c = tid; c < LW; c += NWAVES * 64) { float h = 0.f;
            for (int k = 0; k < ck; ++k) { const size_t rl = (size_t)b * SEQ + k * lru::TK + (lru::TK - 1); h = ACUM[rl * LW + c] * h + HLOC[rl * LW + c]; }
            hin[c] = h; }
        __syncthreads();
        const int rpw = rows_wg / NWAVES;
        for (int j = 0; j < rpw; ++j) { const size_t row = (size_t)r0 + wave * rpw + j;
            f32x4 oa[4], ol[4]; float sa = 0.f, sl = 0.f;
#pragma unroll
            for (int q = 0; q < 4; ++q) { const int c0 = 4 * lane + 256 * q;
                oa[q] = *(const f32x4*)(OATT + row * AW + c0); sa += (oa[q].x * oa[q].x + oa[q].y * oa[q].y) + (oa[q].z * oa[q].z + oa[q].w * oa[q].w);
                const f32x4 hl = *(const f32x4*)(HLOC + row * LW + c0), pc = *(const f32x4*)(ACUM + row * LW + c0), hv = *(const LAS f32x4*)(hin + c0);
                const v2u xg = *(const v2u*)(XG + row * LW + c0);
                f32x4 h = hl + pc * hv;
                h.x *= gelu_tanh(bf_lo(xg.x)); h.y *= gelu_tanh(bf_hi(xg.x)); h.z *= gelu_tanh(bf_lo(xg.y)); h.w *= gelu_tanh(bf_hi(xg.y));
                ol[q] = h; sl += (h.x * h.x + h.y * h.y) + (h.z * h.z + h.w * h.w); }
            const float ra = 1.0f / sqrtf(wave_sum(sa) * (1.f / AW) + EPS), rl = 1.0f / sqrtf(wave_sum(sl) * (1.f / LW) + EPS);
#pragma unroll
            for (int q = 0; q < 4; ++q) { const int c0 = 4 * lane + 256 * q; const f32x4 ga = *(const f32x4*)(g_attn + c0), gl = *(const f32x4*)(g_lru + c0);
                const f32x4 ya = oa[q] * ra * ga, yl = ol[q] * rl * gl;
                v2u o; o.x = cvtpk(ya.x, ya.y); o.y = cvtpk(ya.z, ya.w); *(v2u*)(XN + row * DM + c0) = o;
                o.x = cvtpk(yl.x, yl.y); o.y = cvtpk(yl.z, yl.w); *(v2u*)(XN + row * DM + AW + c0) = o; } }
        __syncthreads();
    }
    SEAM(4);
    if (IN(5)) {
        pg8::Gemm g{XN, WOUT, M, DM, DM}; pg8::StaticOrder S; S.init(M, DM, G, (int)blockIdx.x);
        pg8::EpiRes E{x, out, DM, MOD + 2 * DM, MODW, SEQ};
        pg8::gemm_phase<pg8::EpiRes, pg8::StaticOrder, false, true>(lds, g, S, E);
    }
    SEAM(5);
    if (IN(6)) {
        LAS float* modl = (LAS float*)(lds + MODL_OFF);
        const int b = vcu / (G / BATCH);
        for (int n = tid; n < 2 * DM; n += NWAVES * 64) modl[n] = MOD[(size_t)b * MODW + 3 * DM + n];
        __syncthreads();
        const int rpw = M / (G * NWAVES);
        for (int j = 0; j < rpw; ++j) { const size_t row = (size_t)(vcu * NWAVES + wave) * rpw + j;
            norm_mod_row(out + row * DM, g_mlp, modl, modl + DM, XN + row * DM, lane); }
        __syncthreads();
    }
    SEAM(6);
    if (IN(7)) {
        pg8::Gemm g{XN, WMI, M, FF, DM}; pg8::StaticOrder S; S.init(M, FF, G, (int)blockIdx.x);
        pg8::EpiBf16<2> E{HID, FF, 0, 0, 1.f};
        pg8::gemm_phase<pg8::EpiBf16<2>, pg8::StaticOrder, true, true>(lds, g, S, E);
    }
    SEAM(7);
    if (IN(8)) {
        pg8::Gemm g{HID, WMO, M, DM, FF}; pg8::StaticOrder S; S.init(M, DM, G, (int)blockIdx.x);
        pg8::EpiRes E{out, out, DM, MOD + 5 * DM, MODW, SEQ};
        pg8::gemm_phase<pg8::EpiRes, pg8::StaticOrder, false, true>(lds, g, S, E);
    }
    SEAM(8);
    if (IN(9)) {
        const int rpw = M / (G * NWAVES);
        for (int j = 0; j < rpw; ++j) { const size_t row = (size_t)(vcu * NWAVES + wave) * rpw + j; float* xr = out + row * DM;
            f32x4 v[8]; float s = 0.f;
#pragma unroll
            for (int q = 0; q < 8; ++q) { v[q] = *(const f32x4*)(xr + 4 * lane + 256 * q); s += (v[q].x * v[q].x + v[q].y * v[q].y) + (v[q].z * v[q].z + v[q].w * v[q].w); }
            const float rs = 1.0f / sqrtf(wave_sum(s) * (1.f / DM) + EPS);
#pragma unroll
            for (int q = 0; q < 8; ++q) { const f32x4 gv = *(const f32x4*)(g_fin + 4 * lane + 256 * q); *(f32x4*)(xr + 4 * lane + 256 * q) = v[q] * rs * gv; } }
    }
#undef IN
#undef SEAM
}

extern "C" void kernel_launch(void* const* d_in, const int* in_sizes, int n_in, void* d_out, int out_size, void* d_ws, size_t ws_size, hipStream_t stream) {
    static int grid = 0;
    if (grid == 0) {
        if (n_in != 20 || in_sizes[0] != M * DM || out_size != M * DM || ws_size < WS_END) { fprintf(stderr, "kernel_launch: unexpected shapes / workspace (n_in %d, in0 %d, out %d, ws %zu); nothing launched\n", n_in, n_in > 0 ? in_sizes[0] : -1, out_size, ws_size); grid = -1; return; }
        int dev = 0, cus = 0, per_cu = 0;
        if (hipGetDevice(&dev) != hipSuccess || hipDeviceGetAttribute(&cus, hipDeviceAttributeMultiprocessorCount, dev) != hipSuccess) { fprintf(stderr, "kernel_launch: device query failed\n"); grid = -1; return; }
        if (hipFuncSetAttribute((const void*)mega_fwd, hipFuncAttributeMaxDynamicSharedMemorySize, LDS_BYTES) != hipSuccess) { fprintf(stderr, "kernel_launch: hipFuncSetAttribute failed\n"); grid = -1; return; }
        if (hipOccupancyMaxActiveBlocksPerMultiprocessor(&per_cu, (const void*)mega_fwd, NWAVES * 64, LDS_BYTES) != hipSuccess || per_cu < 1)
            fprintf(stderr, "kernel_launch: note: occupancy query reports %d workgroups per CU\n", per_cu);
        (void)hipGetLastError();
        grid = cus;
        if (grid != 256) { fprintf(stderr, "kernel_launch: this build needs a 256-CU device (got %d)\n", grid); grid = -1; return; }
    }
    if (grid < 0) return;
    if (hipMemsetAsync((char*)d_ws + WS_CTL, 0, CTL_ZERO_BYTES, stream) != hipSuccess) { fprintf(stderr, "kernel_launch: hipMemsetAsync failed\n"); return; }
    Args a{};
    for (int i = 0; i < 20; ++i) a.in[i] = (const float*)d_in[i];
    a.out = (float*)d_out; a.ws = (unsigned char*)d_ws;
    for (int li = 0; li < N_LAUNCHES; ++li) {
        a.ph_lo = (N_LAUNCHES == 1) ? 0 : li; a.ph_hi = (N_LAUNCHES == 1) ? NPH : li + 1; a.li = li;
        hipLaunchKernelGGL(mega_fwd, dim3(grid), dim3(NWAVES * 64), LDS_BYTES, stream, a);
        const hipError_t le = hipPeekAtLastError();
        if (le != hipSuccess) { fprintf(stderr, "kernel_launch: launch %d failed: %s\n", li, hipGetErrorName(le)); break; }
    }
}
```
